# Optimizing an MI355X kernel written in HIP

```python
import math
import jax, jax.numpy as jnp
from jax import lax
import numpy as np

D_MODEL = 1024
BATCH = 8
SEQ = 2048
DEPTH = 1

D_MIX = D_MODEL
SSM_WIDTH = D_MIX // 2
SSM_GROUP = 16
SSM_GROUPS = SSM_WIDTH // SSM_GROUP
SSM_STATE = 64
MLA_HEADS = 4
QK_NOPE = 128
QK_ROPE = 64
QK_DIM = QK_NOPE + QK_ROPE
V_HEAD = 128
MLA_WIDTH = MLA_HEADS * V_HEAD
Q_LORA = 256
KV_LORA = 128
PLE_DIM = 256
ROPE_THETA = 10000.0
Q_BLOCK = 128
LN_EPS = 1e-5
RMS_EPS = 1e-6
DT_MIN = 1e-3
DT_MAX = 1e-1
MAX_POS_OFFSET = 4096
DEEPNORM_ALPHA = (2 * DEPTH) ** 0.25
DEEPNORM_BETA = (8 * DEPTH) ** -0.25

IN_SPLITS = (SSM_WIDTH, SSM_WIDTH, Q_LORA, KV_LORA, QK_ROPE, MLA_WIDTH)
D_IN = sum(IN_SPLITS)
IN_SPLIT_POINTS = tuple(int(v) for v in np.cumsum(IN_SPLITS)[:-1])

kernel_name = "hymba_s5_mla_deepnorm_ple"


def layer_norm(x, g, b):
    xf = x.astype(jnp.float32)
    mu = jnp.mean(xf, axis=-1, keepdims=True)
    var = jnp.mean(jnp.square(xf - mu), axis=-1, keepdims=True)
    return ((xf - mu) * lax.rsqrt(var + LN_EPS)).astype(x.dtype) * g + b


def rms_norm(x, g):
    xf = x.astype(jnp.float32)
    return (xf * lax.rsqrt(jnp.mean(xf * xf, axis=-1, keepdims=True) + RMS_EPS)).astype(x.dtype) * g


def rope_tables(positions):
    inv_freq = 1.0 / (ROPE_THETA ** (jnp.arange(0, QK_ROPE, 2, dtype=jnp.float32) / QK_ROPE))
    ang = positions.astype(jnp.float32)[..., None] * inv_freq
    return jnp.cos(ang), jnp.sin(ang)


def rotary(x, cos, sin):
    xf = x.astype(jnp.float32)
    x1, x2 = jnp.split(xf, 2, axis=-1)
    return jnp.concatenate([x1 * cos - x2 * sin, x2 * cos + x1 * sin], axis=-1).astype(x.dtype)


def s5_branch(u, a_re, a_im, log_dt, b_re, b_im, c_re, c_im, d_skip, w_glu, b_glu):
    bsz, seqlen, _ = u.shape
    f32 = jnp.float32
    uf = u.astype(f32)
    ug = uf.reshape(bsz, seqlen, SSM_GROUPS, SSM_GROUP)
    a_re = a_re.astype(f32)
    a_im = a_im.astype(f32)
    dt = jnp.exp(log_dt.astype(f32))[:, None]
    mag = jnp.exp(dt * a_re)
    ab_re = mag * jnp.cos(dt * a_im)
    ab_im = mag * jnp.sin(dt * a_im)
    den = a_re * a_re + a_im * a_im
    nr = ab_re - 1.0
    k_re = (nr * a_re + ab_im * a_im) / den
    k_im = (ab_im * a_re - nr * a_im) / den
    bu_re = jnp.einsum('gpc,blgc->lbgp', b_re.astype(f32), ug)
    bu_im = jnp.einsum('gpc,blgc->lbgp', b_im.astype(f32), ug)
    x_re = k_re * bu_re - k_im * bu_im
    x_im = k_re * bu_im + k_im * bu_re
    a_seq_re = jnp.broadcast_to(ab_re, (seqlen, 1, SSM_GROUPS, SSM_STATE))
    a_seq_im = jnp.broadcast_to(ab_im, (seqlen, 1, SSM_GROUPS, SSM_STATE))

    def combine(left, right):
        al_re, al_im, bl_re, bl_im = left
        ar_re, ar_im, br_re, br_im = right
        return (al_re * ar_re - al_im * ar_im,
                al_re * ar_im + al_im * ar_re,
                ar_re * bl_re - ar_im * bl_im + br_re,
                ar_re * bl_im + ar_im * bl_re + br_im)

    _, _, h_re, h_im = lax.associative_scan(combine, (a_seq_re, a_seq_im, x_re, x_im), axis=0)
    y = (jnp.einsum('gcp,lbgp->blgc', c_re.astype(f32), h_re)
         - jnp.einsum('gcp,lbgp->blgc', c_im.astype(f32), h_im))
    y = y.reshape(bsz, seqlen, SSM_WIDTH) + d_skip.astype(f32) * uf
    y = jax.nn.gelu(y)
    y = y * jax.nn.sigmoid(y @ w_glu.astype(f32) + b_glu.astype(f32))
    return y.astype(u.dtype)


def mla_branch(cq, ckv, kr, cos, sin, q_norm_g, w_uq, kv_norm_g, w_ukv):
    bsz, seqlen, _ = cq.shape
    q = (rms_norm(cq, q_norm_g) @ w_uq).reshape(bsz, seqlen, MLA_HEADS, QK_DIM)
    q = jnp.concatenate([q[..., :QK_NOPE],
                         rotary(q[..., QK_NOPE:], cos[:, :, None, :], sin[:, :, None, :])], axis=-1)
    kv = (rms_norm(ckv, kv_norm_g) @ w_ukv).reshape(bsz, seqlen, MLA_HEADS, QK_NOPE + V_HEAD)
    k_nope, v = kv[..., :QK_NOPE], kv[..., QK_NOPE:]
    k_rope = rotary(kr, cos, sin)
    k = jnp.concatenate([k_nope, jnp.broadcast_to(k_rope[:, :, None, :],
                                                  (bsz, seqlen, MLA_HEADS, QK_ROPE))], axis=-1)
    scale = QK_DIM ** -0.5
    n_blocks = seqlen // Q_BLOCK
    q_blocks = q.reshape(bsz, n_blocks, Q_BLOCK, MLA_HEADS, QK_DIM).transpose(1, 0, 2, 3, 4)
    key_pos = jnp.arange(seqlen)

    def attend(args):
        qb, start = args
        s = jnp.einsum('bqhd,bkhd->bhqk', qb, k, preferred_element_type=jnp.float32) * scale
        q_pos = start + jnp.arange(Q_BLOCK)
        causal = key_pos[None, :] <= q_pos[:, None]
        s = jnp.where(causal, s, -jnp.inf)
        pr = jax.nn.softmax(s, axis=-1).astype(v.dtype)
        return jnp.einsum('bhqk,bkhd->bqhd', pr, v)

    out = lax.map(attend, (q_blocks, jnp.arange(n_blocks) * Q_BLOCK))
    return out.transpose(1, 0, 2, 3, 4).reshape(bsz, seqlen, MLA_WIDTH)


def setup_inputs(seed: int = 0) -> dict:
    key = jax.random.key(seed)
    ks = jax.random.split(key, 26)
    f32 = jnp.float32
    nrm = lambda k, shape, s: jax.random.normal(k, shape, f32) * s
    x = jax.random.normal(ks[0], (BATCH, SEQ, D_MODEL), f32)
    p = jax.random.normal(ks[1], (DEPTH, BATCH, SEQ, PLE_DIM), f32)
    offsets = jax.random.randint(ks[2], (BATCH, 1), 0, MAX_POS_OFFSET, dtype=jnp.int32)
    positions = (jnp.arange(SEQ, dtype=jnp.int32)[None, :] + offsets).astype(jnp.int32)
    ln_emb_g = 1.0 + nrm(ks[3], (D_MODEL,), 0.05)
    ln_emb_b = nrm(ks[4], (D_MODEL,), 0.02)
    w_in = nrm(ks[5], (DEPTH, D_MODEL, D_IN), D_MODEL ** -0.5)
    a_re = -0.5 * jnp.exp(nrm(ks[6], (DEPTH, SSM_GROUPS, SSM_STATE), 0.05))
    a_im = math.pi * jnp.arange(SSM_STATE, dtype=f32) + nrm(ks[7], (DEPTH, SSM_GROUPS, SSM_STATE), 0.05)
    log_dt = jax.random.uniform(ks[8], (DEPTH, SSM_GROUPS), f32, math.log(DT_MIN), math.log(DT_MAX))
    b_re = nrm(ks[9], (DEPTH, SSM_GROUPS, SSM_STATE, SSM_GROUP), (2 * SSM_GROUP) ** -0.5)
    b_im = nrm(ks[10], (DEPTH, SSM_GROUPS, SSM_STATE, SSM_GROUP), (2 * SSM_GROUP) ** -0.5)
    c_re = nrm(ks[11], (DEPTH, SSM_GROUPS, SSM_GROUP, SSM_STATE), SSM_STATE ** -0.5)
    c_im = nrm(ks[12], (DEPTH, SSM_GROUPS, SSM_GROUP, SSM_STATE), SSM_STATE ** -0.5)
    d_skip = nrm(ks[13], (DEPTH, SSM_WIDTH), 1.0)
    w_glu = nrm(ks[14], (DEPTH, SSM_WIDTH, SSM_WIDTH), SSM_WIDTH ** -0.5)
    b_glu = nrm(ks[15], (DEPTH, SSM_WIDTH), 0.02)
    q_norm_g = 1.0 + nrm(ks[16], (DEPTH, Q_LORA), 0.05)
    w_uq = nrm(ks[17], (DEPTH, Q_LORA, MLA_HEADS * QK_DIM), Q_LORA ** -0.5)
    kv_norm_g = 1.0 + nrm(ks[18], (DEPTH, KV_LORA), 0.05)
    w_ukv = nrm(ks[19], (DEPTH, KV_LORA, MLA_HEADS * (QK_NOPE + V_HEAD)), KV_LORA ** -0.5)
    w_out = nrm(ks[20], (DEPTH, D_MIX, D_MODEL), D_MIX ** -0.5 * DEEPNORM_BETA)
    w_pg = nrm(ks[21], (DEPTH, D_MODEL, D_MODEL), D_MODEL ** -0.5)
    w_pp = nrm(ks[22], (DEPTH, PLE_DIM, D_MODEL), PLE_DIM ** -0.5 * DEEPNORM_BETA)
    ln_g = 1.0 + nrm(ks[23], (DEPTH, D_MODEL), 0.05)
    ln_b = nrm(ks[24], (DEPTH, D_MODEL), 0.02)
    return {"x": x, "p": p, "positions": positions, "ln_emb_g": ln_emb_g, "ln_emb_b": ln_emb_b,
            "w_in": w_in, "a_re": a_re, "a_im": a_im, "log_dt": log_dt,
            "b_re": b_re, "b_im": b_im, "c_re": c_re, "c_im": c_im, "d_skip": d_skip,
            "w_glu": w_glu, "b_glu": b_glu, "q_norm_g": q_norm_g, "w_uq": w_uq,
            "kv_norm_g": kv_norm_g, "w_ukv": w_ukv, "w_out": w_out, "w_pg": w_pg,
            "w_pp": w_pp, "ln_g": ln_g, "ln_b": ln_b}


def reference(x, p, positions, ln_emb_g, ln_emb_b, w_in, a_re, a_im, log_dt,
              b_re, b_im, c_re, c_im, d_skip, w_glu, b_glu, q_norm_g, w_uq,
              kv_norm_g, w_ukv, w_out, w_pg, w_pp, ln_g, ln_b):
    x = layer_norm(x, ln_emb_g, ln_emb_b)
    cos, sin = rope_tables(positions)
    for i in range(DEPTH):
        z = x @ w_in[i]
        xs, gs, cq, ckv, kr, gm = jnp.split(z, IN_SPLIT_POINTS, axis=-1)
        ys = s5_branch(xs, a_re[i], a_im[i], log_dt[i], b_re[i], b_im[i], c_re[i], c_im[i],
                       d_skip[i], w_glu[i], b_glu[i]) * jax.nn.silu(gs)
        ym = mla_branch(cq, ckv, kr, cos, sin, q_norm_g[i], w_uq[i], kv_norm_g[i],
                        w_ukv[i]) * jax.nn.silu(gm)
        mix = jnp.concatenate([ys, ym], axis=-1) @ w_out[i]
        u = DEEPNORM_ALPHA * x + mix
        ple = jax.nn.sigmoid(u @ w_pg[i]) * (p[i] @ w_pp[i])
        x = layer_norm(u + ple, ln_g[i], ln_b[i])
    return x
```

```cpp
#include <hip/hip_runtime.h>
#include <cstdio>
#include <cstdint>

constexpr int BATCH = 8, SEQ = 2048, M = BATCH * SEQ, D = 1024;
constexpr int D_IN = 1984, D_INP = 2048;
constexpr int NG = 32, GC = 16, NS = 64;
constexpr int NH = 4, QKN = 128, QKR = 64, QKD = 192, VH = 128;
constexpr int QL = 256, KVL = 128, PLE = 256;
constexpr int CH = 64, NCH = SEQ / CH;
constexpr float LN_EPS = 1e-5f, RMS_EPS = 1e-6f;
constexpr float ALPHA = 1.189207115002721f;
constexpr float QSCALE = 0.07216878364870322f * 1.4426950408889634f;

constexpr size_t MiB = 1u << 20;
constexpr size_t WS_CTL = 0, CTL_ZERO_BYTES = 128 * 1024;
constexpr size_t WS_STATS = 1 * MiB;
constexpr size_t WS_QSS = WS_STATS + 131072;
constexpr size_t WS_KSS = WS_QSS + 262144;
constexpr size_t WS_A64 = WS_KSS + 262144;
constexpr size_t WS_W1 = 2 * MiB;
constexpr size_t WS_W2 = WS_W1 + 1048576;
constexpr size_t WS_KERN = WS_W2 + 1064960;
constexpr size_t WS_MSTATE = 6 * MiB;
constexpr size_t WS_CMAT = 14 * MiB;
constexpr size_t WS_COSSIN = 22 * MiB;
constexpr size_t WS_WIN = 26 * MiB;
constexpr size_t WS_WUQ = 30 * MiB;
constexpr size_t WS_WUKV = WS_WUQ + 393216;
constexpr size_t WS_WGLU = WS_WUKV + 524288;
constexpr size_t WS_WPP = WS_WGLU + 524288;
constexpr size_t WS_WOUT = 32 * MiB;
constexpr size_t WS_WPG = 34 * MiB;
constexpr size_t WS_PB = 36 * MiB;
constexpr size_t WS_XN = 48 * MiB;
constexpr size_t WS_PP = 48 * MiB;
constexpr size_t WS_XS = 80 * MiB;
constexpr size_t WS_SGM = 96 * MiB;
constexpr size_t WS_SGS = 112 * MiB;
constexpr size_t WS_UB = 80 * MiB;
constexpr size_t WS_ULO = 112 * MiB;
constexpr size_t WS_CQ = 128 * MiB;
constexpr size_t WS_CKV = 136 * MiB;
constexpr size_t WS_QB = 144 * MiB;
constexpr size_t WS_KB = 168 * MiB;
constexpr size_t WS_VT = 192 * MiB;
constexpr size_t WS_YG = 208 * MiB;
constexpr size_t WS_CONCAT = 224 * MiB;
constexpr size_t WS_END = 256 * MiB;

constexpr int CW_BAR = 4096;

constexpr int RING_BYTES = 131072, LDSCTL_OFF = RING_BYTES, MISC_OFF = LDSCTL_OFF + 320, LDS_BYTES = 147456;

#define GAS __attribute__((address_space(1)))
#define LAS __attribute__((address_space(3)))
typedef unsigned short bf16;
typedef unsigned v4u __attribute__((ext_vector_type(4)));
typedef unsigned v2u __attribute__((ext_vector_type(2)));
typedef float f32x4 __attribute__((ext_vector_type(4)));
typedef float f32x2 __attribute__((ext_vector_type(2)));
typedef GAS unsigned gu32;
#define RLX_AGENT __ATOMIC_RELAXED, __HIP_MEMORY_SCOPE_AGENT
__device__ __forceinline__ unsigned f2bf(float f) { unsigned u = __builtin_bit_cast(unsigned, f); return (u + 0x7fffu + ((u >> 16) & 1u)) >> 16; }
__device__ __forceinline__ float bf2f(unsigned h) { return __builtin_bit_cast(float, h << 16); }
__device__ __forceinline__ float rbf(float f) { return bf2f(f2bf(f)); }
__device__ __forceinline__ unsigned pk2(float lo, float hi) { return f2bf(lo) | (f2bf(hi) << 16); }
__device__ __forceinline__ float siluf(float x) { return x / (1.f + __expf(-x)); }
__device__ __forceinline__ float sigmf(float x) { return 1.f / (1.f + __expf(-x)); }
__device__ __forceinline__ float gelu_tanh(float x) { const float z = 0.7978845608028654f * (x + 0.044715f * x * x * x); return 0.5f * x * (1.f + (1.f - 2.f / (1.f + __expf(2.f * z)))); }
__device__ __forceinline__ int vtpos(int m) { return (m & ~12) | ((m & 4) << 1) | ((m & 8) >> 1); }

#define XB_TMO      128
#define XB_XCNT(j)  (256  + 64 * (j))
#define XB_XSUB(j)  (1280 + 64 * (j))
#define XB_XGEN(j)  (2304 + 64 * (j))
#define XB_TOP      3328
#define XB_TOPGEN   3392
#define XCD_BAR_WORDS 3456
#define XB_SPIN_CAP (1u << 25)
__device__ __forceinline__ unsigned xb_ld(unsigned* p)              { return __hip_atomic_load(p, __ATOMIC_RELAXED, __HIP_MEMORY_SCOPE_AGENT); }
__device__ __forceinline__ unsigned xb_add(unsigned* p, unsigned v) { return __hip_atomic_fetch_add(p, v, __ATOMIC_RELAXED, __HIP_MEMORY_SCOPE_AGENT); }
__device__ __forceinline__ unsigned xb_xcc_id() { return (unsigned)__builtin_amdgcn_s_getreg((3 << 11) | 20) & 0xFu; }
#define XB_SPIN(cond, bar) do { unsigned _sp = 0; while (cond) { __builtin_amdgcn_s_sleep(1); \
    if ((++_sp & 255u) == 0u) { if (xb_ld(&(bar)[XB_TMO])) break; if (_sp > XB_SPIN_CAP) { atomicAdd(&(bar)[XB_TMO], 1u); break; } } } } while (0)
struct XcdBarrier { unsigned* bar; unsigned x; volatile LAS unsigned* st; };
__device__ __forceinline__ XcdBarrier xcd_barrier_post(unsigned* bar, volatile LAS unsigned* st) {
    XcdBarrier b; b.bar = bar; b.x = xb_xcc_id(); b.st = st;
    if (threadIdx.x == 0) (void)xb_add(&bar[XB_XCNT(b.x)], 1u);
    return b;
}
__device__ __forceinline__ void xcd_barrier_complete(unsigned* bar, unsigned x, unsigned& nloc, unsigned& nx) {
    const unsigned G = gridDim.x * gridDim.y * gridDim.z;
    unsigned sum, cnt, mine, sp = 0u;
    for (;;) {
        sum = 0u; cnt = 0u; mine = 0u;
#pragma unroll
        for (unsigned j = 0; j < 16; ++j) { const unsigned c = xb_ld(&bar[XB_XCNT(j)]); sum += c; cnt += (c > 0u) ? 1u : 0u; mine = (j == x) ? c : mine; }
        if (sum == G) break;
        __builtin_amdgcn_s_sleep(1);
        if ((++sp & 255u) == 0u) { if (xb_ld(&bar[XB_TMO])) break; if (sp > XB_SPIN_CAP) { atomicAdd(&bar[XB_TMO], 1u); break; } }
    }
    nloc = mine > 0u ? mine : 1u; nx = cnt > 0u ? cnt : 1u;
}
__device__ __forceinline__ void xcd_barrier(const XcdBarrier& b) {
    asm volatile("s_waitcnt vmcnt(0)" ::: "memory");
    __syncthreads();
    if (threadIdx.x == 0) {
        unsigned* bar = b.bar;
        __builtin_amdgcn_s_waitcnt(0);
        unsigned nloc = b.st[0], nx = b.st[1];
        if (nloc == 0u) { xcd_barrier_complete(bar, b.x, nloc, nx); b.st[0] = nloc; b.st[1] = nx; }
        const unsigned old = xb_add(&bar[XB_XSUB(b.x)], 1u);
        const unsigned gen = old / nloc;
        if (old + 1u == (gen + 1u) * nloc) {
            __builtin_amdgcn_fence(__ATOMIC_RELEASE, "agent");
            asm volatile("s_waitcnt vmcnt(0)" ::: "memory");
            const unsigned og = xb_add(&bar[XB_TOP], 1u);
            const unsigned tg = og / nx;
            if (og + 1u == (tg + 1u) * nx) xb_add(&bar[XB_TOPGEN], 1u);
            else XB_SPIN(xb_ld(&bar[XB_TOPGEN]) == tg, bar);
            __builtin_amdgcn_fence(__ATOMIC_ACQUIRE, "agent");
            xb_add(&bar[XB_XGEN(b.x)], 1u);
            asm volatile("s_waitcnt vmcnt(0)" ::: "memory");
        } else {
            XB_SPIN(xb_ld(&bar[XB_XGEN(b.x)]) == gen, bar);
            __builtin_amdgcn_fence(__ATOMIC_ACQUIRE, "agent");
            asm volatile("s_waitcnt vmcnt(0)" ::: "memory");
        }
    }
    __syncthreads();
}

struct Args {
    const float* x; const float* p; const int* pos; const float* ln_emb_g; const float* ln_emb_b; const float* w_in;
    const float* a_re; const float* a_im; const float* log_dt; const float* b_re; const float* b_im; const float* c_re; const float* c_im;
    const float* d_skip; const float* w_glu; const float* b_glu; const float* q_norm_g; const float* w_uq; const float* kv_norm_g; const float* w_ukv;
    const float* w_out; const float* w_pg; const float* w_pp; const float* ln_g; const float* ln_b;
    float* out; unsigned char* ws;
};

__device__ __forceinline__ float wave_sum(float v) {
#pragma unroll
    for (int o = 1; o < 64; o <<= 1) v += __shfl_xor(v, o);
    return v;
}

template <class F>
__device__ __forceinline__ void naive_gemm(const bf16* A, int lda, const bf16* Bt, int ldb, int Mr, int N, int K, const F& f, int gtid, int GT) {
    const int np = N >> 1; const long total = (long)Mr * np;
    for (long idx = gtid; idx < total; idx += GT) {
        const int m = (int)(idx / np), n = (int)(idx % np) * 2;
        const v4u* ar = (const v4u*)(A + (size_t)m * lda); const v4u* b0 = (const v4u*)(Bt + (size_t)n * ldb); const v4u* b1 = (const v4u*)(Bt + (size_t)(n + 1) * ldb);
        float a0 = 0.f, a1 = 0.f;
        for (int k = 0; k < (K >> 3); ++k) {
            const v4u av = ar[k], x0 = b0[k], x1 = b1[k];
#pragma unroll
            for (int j = 0; j < 4; ++j) { const float al = bf2f(av[j] & 0xffffu), ah = bf2f(av[j] >> 16);
                a0 += al * bf2f(x0[j] & 0xffffu) + ah * bf2f(x0[j] >> 16); a1 += al * bf2f(x1[j] & 0xffffu) + ah * bf2f(x1[j] >> 16); }
        }
        f(m, n, a0, a1);
    }
}

struct FRoute { bf16 *XS, *SGS, *CQ, *CKV, *KB, *SGM; const f32x2* CS;
    __device__ __forceinline__ void operator()(int m, int n, float a0, float a1) const {
        if (n < 512) { XS[(size_t)m * 512 + n] = f2bf(a0); XS[(size_t)m * 512 + n + 1] = f2bf(a1); }
        else if (n < 1024) { SGS[(size_t)m * 512 + n - 512] = f2bf(siluf(a0)); SGS[(size_t)m * 512 + n - 511] = f2bf(siluf(a1)); }
        else if (n < 1280) { CQ[(size_t)m * 256 + n - 1024] = f2bf(a0); CQ[(size_t)m * 256 + n - 1023] = f2bf(a1); }
        else if (n < 1408) { CKV[(size_t)m * 256 + n - 1280] = f2bf(a0); CKV[(size_t)m * 256 + n - 1279] = f2bf(a1); }
        else if (n < 1472) { const int i = (n - 1408) >> 1; const f32x2 cs = CS[(size_t)m * 32 + i]; const float o0 = a0 * cs.x - a1 * cs.y, o1 = a1 * cs.x + a0 * cs.y;
#pragma unroll
            for (int h = 0; h < NH; ++h) { KB[(size_t)m * 768 + h * 192 + 128 + 2 * i] = f2bf(o0); KB[(size_t)m * 768 + h * 192 + 129 + 2 * i] = f2bf(o1); } }
        else { SGM[(size_t)m * 512 + n - 1472] = f2bf(siluf(a0)); SGM[(size_t)m * 512 + n - 1471] = f2bf(siluf(a1)); }
    }
};
struct FQ { const bf16* CQ; bf16* QB; const f32x2* CS;
    __device__ __forceinline__ void operator()(int m, int n, float a0, float a1) const {
        float ss = 0.f; const v4u* r = (const v4u*)(CQ + (size_t)m * 256);
        for (int k = 0; k < 32; ++k) { const v4u v = r[k];
#pragma unroll
            for (int j = 0; j < 4; ++j) { const float l = bf2f(v[j] & 0xffffu), h = bf2f(v[j] >> 16); ss += l * l + h * h; } }
        const float rstd = 1.f / sqrtf(ss * (1.f / 256.f) + RMS_EPS);
        a0 *= rstd; a1 *= rstd; const int h = n / 192, j = n % 192;
        if (j >= 128) { const int i = (j - 128) >> 1; const f32x2 cs = CS[(size_t)m * 32 + i]; const float o0 = a0 * cs.x - a1 * cs.y, o1 = a1 * cs.x + a0 * cs.y; a0 = o0; a1 = o1; }
        QB[(size_t)m * 768 + h * 192 + j] = f2bf(a0 * QSCALE); QB[(size_t)m * 768 + h * 192 + j + 1] = f2bf(a1 * QSCALE);
    }
};
struct FKV { const bf16* CKV; bf16* KB; bf16* VT;
    __device__ __forceinline__ void operator()(int m, int n, float a0, float a1) const {
        float ss = 0.f; const v4u* r = (const v4u*)(CKV + (size_t)m * 256);
        for (int k = 0; k < 16; ++k) { const v4u v = r[k];
#pragma unroll
            for (int j = 0; j < 4; ++j) { const float l = bf2f(v[j] & 0xffffu), h = bf2f(v[j] >> 16); ss += l * l + h * h; } }
        const float rstd = 1.f / sqrtf(ss * (1.f / 128.f) + RMS_EPS);
        a0 *= rstd; a1 *= rstd;
        if (n < 512) { const int h = n >> 7, d = n & 127; KB[(size_t)m * 768 + h * 192 + d] = f2bf(a0); KB[(size_t)m * 768 + h * 192 + d + 1] = f2bf(a1); }
        else { const int r2 = n - 512; const int mp = (m & ~(SEQ - 1)) | vtpos(m & (SEQ - 1)); VT[(size_t)r2 * M + mp] = f2bf(a0); VT[(size_t)(r2 + 1) * M + mp] = f2bf(a1); }
    }
};
struct FGlu { const bf16* YG; const bf16* SGS; const float* bg; bf16* CC;
    __device__ __forceinline__ void operator()(int m, int n, float a0, float a1) const {
        const float y0 = bf2f(YG[(size_t)m * 512 + n]), y1 = bf2f(YG[(size_t)m * 512 + n + 1]);
        const float s0 = bf2f(SGS[(size_t)m * 512 + n]), s1 = bf2f(SGS[(size_t)m * 512 + n + 1]);
        CC[(size_t)m * 1024 + n] = f2bf(y0 * sigmf(a0 + bg[n]) * s0); CC[(size_t)m * 1024 + n + 1] = f2bf(y1 * sigmf(a1 + bg[n + 1]) * s1);
    }
};
struct FPP { bf16* PP;
    __device__ __forceinline__ void operator()(int m, int n, float a0, float a1) const { PP[(size_t)m * 1024 + n] = f2bf(a0); PP[(size_t)m * 1024 + n + 1] = f2bf(a1); }
};
struct FMix { const float* x; const f32x2* ST; const float* g; const float* b; bf16* UB; bf16* ULO;
    __device__ __forceinline__ void operator()(int m, int n, float a0, float a1) const {
        const f32x2 st = ST[m];
        const float u0 = ALPHA * ((x[(size_t)m * 1024 + n] - st.x) * st.y * g[n] + b[n]) + a0, u1 = ALPHA * ((x[(size_t)m * 1024 + n + 1] - st.x) * st.y * g[n + 1] + b[n + 1]) + a1;
        const unsigned h0 = f2bf(u0), h1 = f2bf(u1);
        UB[(size_t)m * 1024 + n] = h0; UB[(size_t)m * 1024 + n + 1] = h1; ULO[(size_t)m * 1024 + n] = f2bf(u0 - bf2f(h0)); ULO[(size_t)m * 1024 + n + 1] = f2bf(u1 - bf2f(h1));
    }
};
struct FPg { const bf16* UB; const bf16* ULO; const bf16* PP; float* out;
    __device__ __forceinline__ void operator()(int m, int n, float a0, float a1) const {
        const size_t o = (size_t)m * 1024 + n;
        out[o] = bf2f(UB[o]) + bf2f(ULO[o]) + sigmf(a0) * bf2f(PP[o]); out[o + 1] = bf2f(UB[o + 1]) + bf2f(ULO[o + 1]) + sigmf(a1) * bf2f(PP[o + 1]);
    }
};

__global__ void __launch_bounds__(512, 2) fwd_kernel(Args a) {
    extern __shared__ __attribute__((aligned(16))) unsigned char lds[];
    const int tid = threadIdx.x, lane = tid & 63, wave = __builtin_amdgcn_readfirstlane(tid >> 6);
    const int G = gridDim.x, gtid = blockIdx.x * 512 + tid, GT = G * 512, gw = blockIdx.x * 8 + wave, NGW = G * 8;
    unsigned char* ws = a.ws;
    gu32* ctl = (gu32*)(ws + WS_CTL);
    for (int u = tid; u < (LDS_BYTES - LDSCTL_OFF) / 4; u += 512) ((LAS unsigned*)((LAS unsigned char*)lds + LDSCTL_OFF))[u] = 0u;
    __syncthreads();
    volatile LAS unsigned* MISC = (volatile LAS unsigned*)((LAS unsigned char*)lds + MISC_OFF);
    XcdBarrier bar = xcd_barrier_post((unsigned*)(ctl + CW_BAR), MISC + 8);

    f32x2* STATS = (f32x2*)(ws + WS_STATS); f32x2* COSSIN = (f32x2*)(ws + WS_COSSIN);
    f32x2* W1 = (f32x2*)(ws + WS_W1); f32x2* W2 = (f32x2*)(ws + WS_W2); f32x2* A64 = (f32x2*)(ws + WS_A64);
    bf16* KERN = (bf16*)(ws + WS_KERN); bf16* MSTATE = (bf16*)(ws + WS_MSTATE); bf16* CMAT = (bf16*)(ws + WS_CMAT);
    bf16* WIN = (bf16*)(ws + WS_WIN); bf16* WUQ = (bf16*)(ws + WS_WUQ); bf16* WUKV = (bf16*)(ws + WS_WUKV); bf16* WGLU = (bf16*)(ws + WS_WGLU);
    bf16* WPP = (bf16*)(ws + WS_WPP); bf16* WOUT = (bf16*)(ws + WS_WOUT); bf16* WPG = (bf16*)(ws + WS_WPG);
    bf16* PB = (bf16*)(ws + WS_PB); bf16* XN = (bf16*)(ws + WS_XN); bf16* PP = (bf16*)(ws + WS_PP); bf16* XS = (bf16*)(ws + WS_XS);
    bf16* SGM = (bf16*)(ws + WS_SGM); bf16* SGS = (bf16*)(ws + WS_SGS); bf16* UB = (bf16*)(ws + WS_UB); bf16* ULO = (bf16*)(ws + WS_ULO);
    bf16* CQ = (bf16*)(ws + WS_CQ); bf16* CKV = (bf16*)(ws + WS_CKV); bf16* QB = (bf16*)(ws + WS_QB); bf16* KB = (bf16*)(ws + WS_KB);
    bf16* VT = (bf16*)(ws + WS_VT); bf16* YG = (bf16*)(ws + WS_YG); bf16* CC = (bf16*)(ws + WS_CONCAT);

    for (long i = gtid; i < (long)D_INP * D; i += GT) { const int n = (int)(i >> 10), k = (int)(i & 1023); int o = n;
        if (n >= 1408 && n < 1472) { const int j = n - 1408; o = 1408 + (j >> 1) + 32 * (j & 1); }
        WIN[i] = (n < D_IN) ? f2bf(a.w_in[(size_t)k * D_IN + o]) : 0; }
    for (int i = gtid; i < 768 * 256; i += GT) { const int n = i >> 8, k = i & 255, h = n / 192, j = n % 192; int o = j;
        if (j >= 128) { const int jj = j - 128; o = 128 + (jj >> 1) + 32 * (jj & 1); }
        WUQ[i] = f2bf(a.w_uq[(size_t)k * 768 + h * 192 + o] * a.q_norm_g[k]); }
    for (int i = gtid; i < 1024 * 256; i += GT) { const int n = i >> 8, k = i & 255; const int o = (n < 512) ? ((n >> 7) * 256 + (n & 127)) : (((n - 512) >> 7) * 256 + 128 + ((n - 512) & 127));
        WUKV[i] = (k < 128) ? f2bf(a.w_ukv[(size_t)k * 1024 + o] * a.kv_norm_g[k]) : 0; }
    for (int i = gtid; i < 512 * 512; i += GT) { const int n = i >> 9, k = i & 511; WGLU[i] = f2bf(a.w_glu[(size_t)k * 512 + n]); }
    for (int i = gtid; i < 1024 * 256; i += GT) { const int n = i >> 8, k = i & 255; WPP[i] = f2bf(a.w_pp[(size_t)k * 1024 + n]); }
    for (int i = gtid; i < 1024 * 1024; i += GT) { const int n = i >> 10, k = i & 1023; WOUT[i] = f2bf(a.w_out[(size_t)k * 1024 + n]); WPG[i] = f2bf(a.w_pg[(size_t)k * 1024 + n]); }
    for (int i = gtid; i < M * 256 / 4; i += GT) { const f32x4 v = ((const f32x4*)a.p)[i]; v2u o; o.x = pk2(v.x, v.y); o.y = pk2(v.z, v.w); ((v2u*)PB)[i] = o; }
    for (int i = gtid; i < M * 16; i += GT) { const int m = i >> 4, c = i & 15; ((v4u*)(CKV + (size_t)m * 256 + 128))[c] = (v4u){0u, 0u, 0u, 0u}; }
    for (int i = gtid; i < M * 32; i += GT) { const int m = i >> 5, j = i & 31;
        const double inv = exp2(-(double)j * (13.287712379549449 / 32.0));
        double ang = (double)a.pos[m] * inv; ang -= 6.283185307179586 * floor(ang * 0.15915494309189535);
        float s, c; sincosf((float)ang, &s, &c); COSSIN[i] = (f32x2){c, s}; }
    for (int m = gw; m < M; m += NGW) {
        const f32x4* xr = (const f32x4*)(a.x + (size_t)m * D) + lane; f32x4 v[4]; float s = 0.f;
#pragma unroll
        for (int j = 0; j < 4; ++j) { v[j] = xr[64 * j]; s += (v[j].x + v[j].y) + (v[j].z + v[j].w); }
        const float mean = wave_sum(s) * (1.f / D); float s2 = 0.f;
#pragma unroll
        for (int j = 0; j < 4; ++j) { v[j] = v[j] - mean; s2 += (v[j].x * v[j].x + v[j].y * v[j].y) + (v[j].z * v[j].z + v[j].w * v[j].w); }
        const float rstd = 1.f / sqrtf(wave_sum(s2) * (1.f / D) + LN_EPS);
        if (lane == 0) STATS[m] = (f32x2){mean, rstd};
        v2u* o8 = (v2u*)(XN + (size_t)m * D) + lane;
#pragma unroll
        for (int j = 0; j < 4; ++j) { const f32x4 g = ((const f32x4*)a.ln_emb_g)[lane + 64 * j], b = ((const f32x4*)a.ln_emb_b)[lane + 64 * j]; const f32x4 y = v[j] * rstd * g + b;
            v2u o; o.x = pk2(y.x, y.y); o.y = pk2(y.z, y.w); o8[64 * j] = o; }
    }
    for (int i = gtid; i < NG * 65 * NS; i += GT) { const int p = i & 63, tau = (i >> 6) % 65, g = i / (65 * 64);
        const double dt = exp((double)a.log_dt[g]), ar = a.a_re[g * NS + p], ai = a.a_im[g * NS + p];
        const double mag1 = exp(dt * ar), abr = mag1 * cos(dt * ai), abi = mag1 * sin(dt * ai), den = ar * ar + ai * ai, nr = abr - 1.0;
        const double kr = (nr * ar + abi * ai) / den, ki = (abi * ar - nr * ai) / den;
        const double mg = exp(tau * dt * ar), pr = mg * cos(tau * dt * ai), pi = mg * sin(tau * dt * ai);
        W2[(g * 65 + tau) * NS + p] = (f32x2){(float)pr, (float)pi};
        if (tau < 64) W1[(g * 64 + tau) * NS + p] = (f32x2){(float)(pr * kr - pi * ki), (float)(pr * ki + pi * kr)};
        if (tau == 64) A64[g * NS + p] = (f32x2){(float)pr, (float)pi}; }
    xcd_barrier(bar);

    for (int i = gtid; i < NG * 65 * 256; i += GT) { const int ci = i & 15, co = (i >> 4) & 15, t1 = (i >> 8) % 65, g = i / (65 * 256); float s = 0.f;
        if (t1 > 0) for (int p = 0; p < NS; ++p) { const f32x2 w = W1[(g * 64 + t1 - 1) * NS + p]; const float cr = a.c_re[(g * GC + co) * NS + p], cim = a.c_im[(g * GC + co) * NS + p];
            const float cwr = cr * w.x - cim * w.y, cwi = cr * w.y + cim * w.x; s += cwr * a.b_re[(g * NS + p) * GC + ci] - cwi * a.b_im[(g * NS + p) * GC + ci]; }
        KERN[i] = f2bf(s); }
    for (int i = gtid; i < NG * 128 * 1024; i += GT) { const int ci = i & 15, j = (i >> 4) & 63, comp = (i >> 10) & 127, g = i >> 17, p = comp & 63, ri = comp >> 6;
        const f32x2 w = W1[(g * 64 + 63 - j) * NS + p]; const float br = a.b_re[(g * NS + p) * GC + ci], bi = a.b_im[(g * NS + p) * GC + ci];
        MSTATE[i] = f2bf(ri == 0 ? (w.x * br - w.y * bi) : (w.x * bi + w.y * br)); }
    for (int i = gtid; i < NG * 1024 * 128; i += GT) { const int comp = i & 127, co = (i >> 7) & 15, t = (i >> 11) & 63, g = i >> 17, p = comp & 63, ri = comp >> 6;
        const f32x2 w = W2[(g * 65 + t + 1) * NS + p]; const float cr = a.c_re[(g * GC + co) * NS + p], cim = a.c_im[(g * GC + co) * NS + p];
        CMAT[i] = f2bf(ri == 0 ? (cr * w.x - cim * w.y) : -(cr * w.y + cim * w.x)); }
    { FRoute f{XS, SGS, CQ, CKV, KB, SGM, COSSIN}; naive_gemm(XN, D, WIN, D, M, D_IN, D, f, gtid, GT); }
    xcd_barrier(bar);

    { FQ f{CQ, QB, COSSIN}; naive_gemm(CQ, 256, WUQ, 256, M, 768, 256, f, gtid, GT); }
    { FKV f{CKV, KB, VT}; naive_gemm(CKV, 256, WUKV, 256, M, 1024, 128, f, gtid, GT); }
    for (int unit = blockIdx.x; unit < BATCH * NG; unit += G) {
        const int b = unit / NG, g = unit % NG;
        LAS float* SL = (LAS float*)lds; LAS float* HL = SL + 32 * 128;
        const bf16* xs0 = XS + (size_t)b * SEQ * 512 + g * GC;
        for (int o = tid; o < 32 * 128; o += 512) { const int comp = o & 127, k = o >> 7; float s = 0.f; const bf16* ms = MSTATE + ((size_t)g * 128 + comp) * 1024;
            for (int j = 0; j < CH; ++j) { const bf16* ur = xs0 + (size_t)(k * CH + j) * 512;
#pragma unroll
                for (int ci = 0; ci < GC; ++ci) s += bf2f(ms[j * 16 + ci]) * bf2f(ur[ci]); }
            SL[k * 128 + comp] = s; }
        __syncthreads();
        if (tid < NS) { const f32x2 aa = A64[g * NS + tid]; float hr = 0.f, hi = 0.f;
            for (int k = 0; k < NCH; ++k) { HL[k * 128 + tid] = rbf(hr); HL[k * 128 + 64 + tid] = rbf(hi);
                const float nr = aa.x * hr - aa.y * hi + SL[k * 128 + tid], ni = aa.x * hi + aa.y * hr + SL[k * 128 + 64 + tid]; hr = nr; hi = ni; } }
        __syncthreads();
        for (int o = tid; o < SEQ * GC; o += 512) { const int co = o & 15, t = o >> 4, k = t >> 6, tt = t & 63; float s = 0.f;
            const bf16* kn = KERN + (size_t)g * 65 * 256 + co * 16;
            for (int j = 0; j <= tt; ++j) { const bf16* ur = xs0 + (size_t)(k * CH + j) * 512; const bf16* kr = kn + (tt - j + 1) * 256;
#pragma unroll
                for (int ci = 0; ci < GC; ++ci) s += bf2f(kr[ci]) * bf2f(ur[ci]); }
            const bf16* cm = CMAT + ((size_t)g * 1024 + tt * 16 + co) * 128;
            for (int c = 0; c < 128; ++c) s += bf2f(cm[c]) * HL[k * 128 + c];
            s += a.d_skip[g * GC + co] * bf2f(xs0[(size_t)t * 512 + co]);
            YG[((size_t)b * SEQ + t) * 512 + g * GC + co] = f2bf(gelu_tanh(s)); }
        __syncthreads();
    }
    xcd_barrier(bar);

    {
        LAS float* sc = (LAS float*)lds + wave * SEQ;
        for (int r = gw; r < M * NH; r += NGW) {
            const int m = r >> 2, h = r & 3, b = m >> 11, q = m & (SEQ - 1);
            const bf16* qr = QB + (size_t)m * 768 + h * 192; float mx = -1e30f;
            for (int k0 = 0; k0 <= q; k0 += 64) { const int key = k0 + lane; float s = -1e30f;
                if (key <= q) { const v4u* kr = (const v4u*)(KB + ((size_t)b * SEQ + key) * 768 + h * 192); s = 0.f;
                    for (int d = 0; d < 24; ++d) { const v4u kv = kr[d], qv = ((const v4u*)qr)[d];
#pragma unroll
                        for (int j = 0; j < 4; ++j) s += bf2f(kv[j] & 0xffffu) * bf2f(qv[j] & 0xffffu) + bf2f(kv[j] >> 16) * bf2f(qv[j] >> 16); } }
                sc[key] = s; mx = fmaxf(mx, s); }
#pragma unroll
            for (int o = 1; o < 64; o <<= 1) mx = fmaxf(mx, __shfl_xor(mx, o));
            float l = 0.f; const int kend = (q & ~63) + 64;
            for (int key = lane; key < kend; key += 64) { const float pv = (key <= q) ? exp2f(sc[key] - mx) : 0.f; l += pv; sc[key] = rbf(pv); }
            l = wave_sum(l);
#pragma unroll
            for (int dd = 0; dd < 2; ++dd) { const int dv = lane + 64 * dd; const bf16* vr = VT + (size_t)(h * 128 + dv) * M + (size_t)b * SEQ; float o = 0.f;
                for (int key = 0; key <= q; ++key) o += sc[key] * bf2f(vr[vtpos(key)]);
                CC[(size_t)m * 1024 + 512 + h * 128 + dv] = f2bf(o / l * bf2f(SGM[(size_t)m * 512 + h * 128 + dv])); }
        }
    }
    { FGlu f{YG, SGS, a.b_glu, CC}; naive_gemm(YG, 512, WGLU, 512, M, 512, 512, f, gtid, GT); }
    { FPP f{PP}; naive_gemm(PB, 256, WPP, 256, M, 1024, 256, f, gtid, GT); }
    xcd_barrier(bar);

    { FMix f{a.x, STATS, a.ln_emb_g, a.ln_emb_b, UB, ULO}; naive_gemm(CC, 1024, WOUT, 1024, M, 1024, 1024, f, gtid, GT); }
    xcd_barrier(bar);

    { FPg f{UB, ULO, PP, a.out}; naive_gemm(UB, 1024, WPG, 1024, M, 1024, 1024, f, gtid, GT); }
    xcd_barrier(bar);
    for (int m = gw; m < M; m += NGW) {
        f32x4* xr = (f32x4*)(a.out + (size_t)m * D) + lane; f32x4 v[4]; float s = 0.f;
#pragma unroll
        for (int j = 0; j < 4; ++j) { v[j] = xr[64 * j]; s += (v[j].x + v[j].y) + (v[j].z + v[j].w); }
        const float mean = wave_sum(s) * (1.f / D); float s2 = 0.f;
#pragma unroll
        for (int j = 0; j < 4; ++j) { v[j] = v[j] - mean; s2 += (v[j].x * v[j].x + v[j].y * v[j].y) + (v[j].z * v[j].z + v[j].w * v[j].w); }
        const float rstd = 1.f / sqrtf(wave_sum(s2) * (1.f / D) + LN_EPS);
#pragma unroll
        for (int j = 0; j < 4; ++j) { const f32x4 g = ((const f32x4*)a.ln_g)[lane + 64 * j], b = ((const f32x4*)a.ln_b)[lane + 64 * j]; xr[64 * j] = v[j] * rstd * g + b; }
    }
}

extern "C" void kernel_launch(void* const* d_in, const int* in_sizes, int n_in, void* d_out, int out_size, void* d_ws, size_t ws_size, hipStream_t stream) {
    static int grid = 0;
    if (grid == 0) {
        if (n_in != 25 || in_sizes[0] != M * D || out_size != M * D || ws_size < WS_END) { fprintf(stderr, "kernel_launch: unexpected shapes (n_in %d, in0 %d, out %d, ws %zu); nothing launched\n", n_in, n_in > 0 ? in_sizes[0] : -1, out_size, ws_size); grid = -1; return; }
        int dev = 0, cus = 0, per_cu = 0;
        if (hipGetDevice(&dev) != hipSuccess || hipDeviceGetAttribute(&cus, hipDeviceAttributeMultiprocessorCount, dev) != hipSuccess) { grid = -1; return; }
        if (hipFuncSetAttribute((const void*)fwd_kernel, hipFuncAttributeMaxDynamicSharedMemorySize, LDS_BYTES) != hipSuccess) { fprintf(stderr, "kernel_launch: hipFuncSetAttribute failed\n"); grid = -1; return; }
        if (hipOccupancyMaxActiveBlocksPerMultiprocessor(&per_cu, (const void*)fwd_kernel, 512, LDS_BYTES) != hipSuccess || per_cu < 1) { fprintf(stderr, "kernel_launch: occupancy query reports %d workgroups per CU\n", per_cu); per_cu = 1; }
        (void)hipGetLastError();
        grid = cus;
    }
    if (grid < 0) return;
    (void)hipMemsetAsync((char*)d_ws + WS_CTL, 0, CTL_ZERO_BYTES, stream);
    Args a{};
    a.x = (const float*)d_in[0]; a.p = (const float*)d_in[1]; a.pos = (const int*)d_in[2]; a.ln_emb_g = (const float*)d_in[3]; a.ln_emb_b = (const float*)d_in[4]; a.w_in = (const float*)d_in[5];
    a.a_re = (const float*)d_in[6]; a.a_im = (const float*)d_in[7]; a.log_dt = (const float*)d_in[8]; a.b_re = (const float*)d_in[9]; a.b_im = (const float*)d_in[10]; a.c_re = (const float*)d_in[11]; a.c_im = (const float*)d_in[12];
    a.d_skip = (const float*)d_in[13]; a.w_glu = (const float*)d_in[14]; a.b_glu = (const float*)d_in[15]; a.q_norm_g = (const float*)d_in[16]; a.w_uq = (const float*)d_in[17]; a.kv_norm_g = (const float*)d_in[18]; a.w_ukv = (const float*)d_in[19];
    a.w_out = (const float*)d_in[20]; a.w_pg = (const float*)d_in[21]; a.w_pp = (const float*)d_in[22]; a.ln_g = (const float*)d_in[23]; a.ln_b = (const float*)d_in[24];
    a.out = (float*)d_out; a.ws = (unsigned char*)d_ws;
    hipLaunchKernelGGL(fwd_kernel, dim3(grid), dim3(512), LDS_BYTES, stream, a);
}
```
